# Optimizing an MI355X kernel written in HIP

```python
import math
import jax, jax.numpy as jnp
from jax import lax
import numpy as np

D_MODEL = 2048
BATCH = 1
SEQ = 16384
DEPTH = 4

N_MEM = 256
N_A_LAYERS = DEPTH // 2
N_B_LAYERS = DEPTH - N_A_LAYERS
HEAD_DIM = 128
MIX_WIDTH = D_MODEL
MEM_HEADS = 4
MEM_WIDTH = MEM_HEADS * HEAD_DIM
BRANCH_WIDTH = MIX_WIDTH - MEM_WIDTH
POOL_WINDOWS = (2, 4, 8, 16)
N_POOL_GROUPS = len(POOL_WINDOWS)
POOL_GROUP = BRANCH_WIDTH // N_POOL_GROUPS
MOBA_HEADS = BRANCH_WIDTH // HEAD_DIM
MOBA_BLOCK = 256
MOBA_TOPK = 3
Q_CHUNK = 64
IN_WIDTH = 2 * BRANCH_WIDTH + 2 * MEM_WIDTH
DEEPNORM_ALPHA = (2 * DEPTH) ** 0.25
DEEPNORM_BETA = (8 * DEPTH) ** -0.25
LN_EPS = 1e-5

kernel_name = "yoco_pool_moba_hybrid"


def layer_norm(x, g, b):
    xf = x.astype(jnp.float32)
    mu = xf.mean(-1, keepdims=True)
    var = jnp.square(xf - mu).mean(-1, keepdims=True)
    return ((xf - mu) * lax.rsqrt(var + LN_EPS) * g + b).astype(x.dtype)


def multiscale_pool(u, pool_w, pool_scale):
    B, S, _ = u.shape
    uf = u.astype(jnp.float32)
    cs = jnp.concatenate([jnp.zeros((B, 1, BRANCH_WIDTH), jnp.float32),
                          jnp.cumsum(uf, axis=1)], axis=1)
    t = jnp.arange(S)
    outs = []
    for g, w in enumerate(POOL_WINDOWS):
        sl = slice(g * POOL_GROUP, (g + 1) * POOL_GROUP)
        csg = cs[:, :, sl]
        lo = jnp.maximum(t + 1 - w, 0)
        cnt = (t + 1 - lo).astype(jnp.float32)
        outs.append((csg[:, 1:] - csg[:, lo]) / cnt[None, :, None] - uf[:, :, sl])
    pooled = jnp.stack(outs, axis=2).astype(u.dtype)
    mixed = jnp.einsum('bsgc,gcd->bsgd', pooled, pool_w).reshape(B, S, BRANCH_WIDTH)
    return mixed * pool_scale


def memory_attention(mq, mem, w_mem_kv):
    B, S, _ = mq.shape
    M = mem.shape[1]
    mk, mv = jnp.split(mem @ w_mem_kv, 2, axis=-1)
    q = mq.reshape(B, S, MEM_HEADS, HEAD_DIM)
    k = mk.reshape(B, M, MEM_HEADS, HEAD_DIM)
    v = mv.reshape(B, M, MEM_HEADS, HEAD_DIM)
    s = jnp.einsum('bshd,bmhd->bhsm', q, k).astype(jnp.float32) * (HEAD_DIM ** -0.5)
    p = jax.nn.softmax(s, axis=-1).astype(v.dtype)
    return jnp.einsum('bhsm,bmhd->bshd', p, v).reshape(B, S, MEM_WIDTH)


def moba_shared_kv(h, w_kv):
    B, S, _ = h.shape
    k, v = jnp.split(h @ w_kv, 2, axis=-1)
    nb = -(-S // MOBA_BLOCK)
    pad = nb * MOBA_BLOCK - S
    k = k.reshape(B, S, MOBA_HEADS, HEAD_DIM).transpose(0, 2, 1, 3)
    v = v.reshape(B, S, MOBA_HEADS, HEAD_DIM).transpose(0, 2, 1, 3)
    k = jnp.pad(k, ((0, 0), (0, 0), (0, pad), (0, 0)))
    v = jnp.pad(v, ((0, 0), (0, 0), (0, pad), (0, 0)))
    k_blocks = k.reshape(B, MOBA_HEADS, nb, MOBA_BLOCK, HEAD_DIM)
    v_blocks = v.reshape(B, MOBA_HEADS, nb, MOBA_BLOCK, HEAD_DIM)
    k_mean = k_blocks.astype(jnp.float32).mean(axis=3).astype(k.dtype)
    return k_blocks, v_blocks, k_mean


def moba_attention(q_in, k_blocks, v_blocks, k_mean):
    B, S, _ = q_in.shape
    H = MOBA_HEADS
    nb = k_blocks.shape[2]
    n_sel = min(MOBA_TOPK, nb)
    scale = HEAD_DIM ** -0.5
    q = q_in.reshape(B, S, H, HEAD_DIM).transpose(0, 2, 1, 3)
    b_idx = jnp.arange(B)[:, None, None, None]
    h_idx = jnp.arange(H)[None, :, None, None]
    blk_ids = jnp.arange(nb)
    blk_offs = jnp.arange(MOBA_BLOCK)

    def chunk(c):
        start = c * Q_CHUNK
        qc = lax.dynamic_slice_in_dim(q, start, Q_CHUNK, axis=2)
        own = start // MOBA_BLOCK
        q_pos = start + jnp.arange(Q_CHUNK)
        gate = jnp.einsum('bhqd,bhnd->bhqn', qc, k_mean).astype(jnp.float32)
        gate = jnp.where(blk_ids < own, gate, -jnp.inf)
        _, sel = lax.top_k(gate, n_sel)
        valid = sel < own
        kg = k_blocks[b_idx, h_idx, sel]
        vg = v_blocks[b_idx, h_idx, sel]
        s_sel = jnp.einsum('bhqd,bhqjkd->bhqjk', qc, kg).astype(jnp.float32) * scale
        s_sel = jnp.where(valid[..., None], s_sel, -jnp.inf)
        s_sel = s_sel.reshape(B, H, Q_CHUNK, n_sel * MOBA_BLOCK)
        k_own = lax.dynamic_index_in_dim(k_blocks, own, axis=2, keepdims=False)
        v_own = lax.dynamic_index_in_dim(v_blocks, own, axis=2, keepdims=False)
        s_own = jnp.einsum('bhqd,bhkd->bhqk', qc, k_own).astype(jnp.float32) * scale
        k_pos = own * MOBA_BLOCK + blk_offs
        s_own = jnp.where(k_pos[None, :] <= q_pos[:, None], s_own, -jnp.inf)
        p = jax.nn.softmax(jnp.concatenate([s_sel, s_own], axis=-1), axis=-1).astype(v_blocks.dtype)
        p_sel = p[..., :n_sel * MOBA_BLOCK].reshape(B, H, Q_CHUNK, n_sel, MOBA_BLOCK)
        p_own = p[..., n_sel * MOBA_BLOCK:]
        return (jnp.einsum('bhqjk,bhqjkd->bhqd', p_sel, vg)
                + jnp.einsum('bhqk,bhkd->bhqd', p_own, v_own))

    out = lax.map(chunk, jnp.arange(S // Q_CHUNK))
    return out.transpose(1, 0, 3, 2, 4).reshape(B, S, H * HEAD_DIM)


def setup_inputs(seed: int = 0) -> dict:
    key = jax.random.key(seed)
    ks = jax.random.split(key, 10)
    f32 = jnp.float32
    nrm = jax.random.normal
    x = nrm(ks[0], (BATCH, SEQ, D_MODEL), f32)
    mem = nrm(ks[1], (BATCH, N_MEM, D_MODEL), f32)
    w_in = nrm(ks[2], (DEPTH, D_MODEL, IN_WIDTH), f32) * D_MODEL ** -0.5
    w_out = nrm(ks[3], (DEPTH, MIX_WIDTH, D_MODEL), f32) * (MIX_WIDTH ** -0.5 * DEEPNORM_BETA)
    w_mem_kv = nrm(ks[4], (DEPTH, D_MODEL, 2 * MEM_WIDTH), f32) * D_MODEL ** -0.5
    ln_g = 1.0 + 0.02 * nrm(ks[5], (DEPTH, D_MODEL), f32)
    ln_b = 0.02 * nrm(ks[6], (DEPTH, D_MODEL), f32)
    pool_w = nrm(ks[7], (N_A_LAYERS, N_POOL_GROUPS, POOL_GROUP, POOL_GROUP), f32) * POOL_GROUP ** -0.5
    pool_scale = 1.0 + 0.02 * nrm(ks[8], (N_A_LAYERS, BRANCH_WIDTH), f32)
    w_kv_shared = nrm(ks[9], (D_MODEL, 2 * BRANCH_WIDTH), f32) * D_MODEL ** -0.5
    return {"x": x, "mem": mem, "w_in": w_in, "w_out": w_out, "w_mem_kv": w_mem_kv,
            "ln_g": ln_g, "ln_b": ln_b, "pool_w": pool_w, "pool_scale": pool_scale,
            "w_kv_shared": w_kv_shared}


def reference(x, mem, w_in, w_out, w_mem_kv, ln_g, ln_b, pool_w, pool_scale, w_kv_shared):
    h = x
    split_at = [BRANCH_WIDTH, 2 * BRANCH_WIDTH, 2 * BRANCH_WIDTH + MEM_WIDTH]
    for i in range(DEPTH):
        if i == N_A_LAYERS:
            k_blocks, v_blocks, k_mean = moba_shared_kv(h, w_kv_shared)
        u = h @ w_in[i]
        branch_in, gate_b, mem_q, gate_m = jnp.split(u, split_at, axis=-1)
        if i < N_A_LAYERS:
            branch = multiscale_pool(branch_in, pool_w[i], pool_scale[i])
        else:
            branch = moba_attention(branch_in, k_blocks, v_blocks, k_mean)
        mem_o = memory_attention(mem_q, mem, w_mem_kv[i])
        mixed = jnp.concatenate([branch * jax.nn.silu(gate_b), mem_o * jax.nn.silu(gate_m)], axis=-1)
        y = mixed @ w_out[i]
        h = layer_norm(DEEPNORM_ALPHA * h + y, ln_g[i], ln_b[i])
    return h
```

```cpp
#include <hip/hip_runtime.h>
#include <hip/hip_cooperative_groups.h>
#include <cstdio>
#include <cstdint>
namespace cg = cooperative_groups;
namespace pg8 {
#define PG8_LAS __attribute__((address_space(3)))
typedef unsigned short bf16_t;
typedef short bf16x8 __attribute__((ext_vector_type(8)));
typedef float f32x4 __attribute__((ext_vector_type(4)));
typedef unsigned u32x4 __attribute__((ext_vector_type(4)));
constexpr int BM = 256, BK = 64, HALF = 128, HTB = HALF * BK * 2  , STAGE_BYTES = 8 * HTB, NXCD = 8, WGM = 8;

__host__ __device__ __forceinline__ int lds_byte(int r, int c) { const int st = (r >> 4) * 2 + (c >> 5), rr = r & 15, cc = c & 31, ob = rr * 64 + cc * 2; return st * 1024 + (ob ^ (((ob >> 9) & 1) << 5)); }
__host__ __device__ __forceinline__ void stage_rc(int b, int& R, int& C) { const int st = b / 1024, sb = b % 1024, swz = sb ^ (((sb >> 9) & 1) << 5); R = (st >> 1) * 16 + swz / 64; C = (st & 1) * 32 + (swz % 64) / 2; }
__host__ __device__ __forceinline__ int perm32(int rho) { const int n = rho >> 4, i = rho & 15; return 8 * (i >> 2) + 4 * n + (i & 3); }

struct Unit { int pm, pn; };
struct Gemm { const bf16_t* A; const bf16_t* Bt; int M, N, K; };

struct StaticOrder {
    int nM, nN, nwg, G, c;
    __host__ __device__ void init(int M, int N, int G_, int c_) { nM = M / BM; nN = N / BM; nwg = nM * nN; G = G_; c = c_; }
    __host__ __device__ bool next(int i, Unit& u) const {
        const long L = (long)i * G + c; if (L >= nwg) return false;
        int wgid = (int)L; { const int q = nwg / NXCD, r = nwg % NXCD, xcd = wgid % NXCD, off = wgid / NXCD; wgid = (xcd < r ? xcd * (q + 1) : r * (q + 1) + (xcd - r) * q) + off; }
        const int nig = WGM * nN, gid = wgid / nig, fm = gid * WGM, gsz = (nM - fm) < WGM ? (nM - fm) : WGM;
        u.pm = fm + ((wgid % nig) % gsz); u.pn = (wgid % nig) / gsz; return true;
    }
    __device__ __forceinline__ void a_ready(const Unit&) const {}
    __device__ __forceinline__ void done(const Unit&) const {}
};
__device__ __forceinline__ int opaque_tid() { int t = threadIdx.x; asm volatile("" : "+v"(t)); return t; }
__device__ __forceinline__ unsigned cvt_pk_bf16(float lo, float hi) { unsigned r; asm volatile("v_cvt_pk_bf16_f32 %0, %1, %2" : "=v"(r) : "v"(lo), "v"(hi)); return r; }

template <class Epi, class Sched, bool ALIGN_EPI = false, bool SP2 = false>
__device__ __forceinline__ void gemm_phase(PG8_LAS unsigned char* lds, const Gemm g, const Sched& S, const Epi& E) {
    const int tid = opaque_tid(), wid = __builtin_amdgcn_readfirstlane(tid >> 6), lane = tid & 63, wr = wid >> 2, wc = wid & 3, fr = lane & 15, fq = lane >> 4;
    const int K = g.K, nt = K / BK;
    unsigned voffA[2], voffB[2];
#pragma unroll
    for (int i = 0; i < 2; ++i) { int R, C; stage_rc(tid * 16 + i * 8192, R, C); const int Rb = Epi::PERM ? ((R & ~31) + perm32(R & 31)) : R;
        voffA[i] = (unsigned)(R * K + C) * 2u; voffB[i] = (unsigned)(Rb * K + C) * 2u; }
    const size_t kstep = (size_t)(BK * 2);
    const size_t hstep = (size_t)HALF * K * 2;
    const size_t tstep = 2 * hstep;
    const unsigned ldsw = (unsigned)wid * 1024u;
    const int aoff = lds_byte(wr * 64 + fr, fq * 8), boff = lds_byte(wc * 32 + fr, fq * 8);
#define PG8_SA(b, h) (((b) * 2 + (h)) * HTB)
#define PG8_SB(b, h) ((4 + (b) * 2 + (h)) * HTB)
#define PG8_STAGE(bufoff, gbase, voff) do { _Pragma("unroll") for (int _i = 0; _i < 2; ++_i) \
        __builtin_amdgcn_global_load_lds((const unsigned*)((const char*)(gbase) + (voff)[_i]), (PG8_LAS unsigned*)(lds + (bufoff) + ldsw + _i * 8192), 16, 0, 0); } while (0)
#define PG8_LDA(dst, b, h) do { _Pragma("unroll") for (int m = 0; m < 4; ++m) _Pragma("unroll") for (int k = 0; k < 2; ++k) dst[m][k] = *(const PG8_LAS bf16x8*)(lds + PG8_SA(b, h) + aoff + m * 2048 + k * 1024); } while (0)
#define PG8_LDB(dst, b, h) do { _Pragma("unroll") for (int n = 0; n < 2; ++n) _Pragma("unroll") for (int k = 0; k < 2; ++k) dst[n][k] = *(const PG8_LAS bf16x8*)(lds + PG8_SB(b, h) + boff + n * 2048 + k * 1024); } while (0)
#define PG8_MMA(ai, bj, At, Bt) do { __builtin_amdgcn_s_setprio(1); _Pragma("unroll") for (int m = 0; m < 4; ++m) _Pragma("unroll") for (int n = 0; n < 2; ++n) _Pragma("unroll") for (int k = 0; k < 2; ++k) \
        acc[ai][bj][m][n] = __builtin_amdgcn_mfma_f32_16x16x32_bf16(Bt[n][k], At[m][k], acc[ai][bj][m][n], 0, 0, 0); __builtin_amdgcn_s_setprio(0); } while (0)
#define PG8_WAIT_V(n) asm volatile("s_waitcnt vmcnt(" #n ")" ::: "memory")
#define PG8_WAIT_L(n) asm volatile("s_waitcnt lgkmcnt(" #n ")" ::: "memory")
#define PG8_BAR __builtin_amdgcn_s_barrier()
#define PG8_SCHED __builtin_amdgcn_sched_barrier(0)
    Unit cur, nxt; int ui = 0;
    if (!S.next(0, cur)) return;
    f32x4 acc[2][2][4][2];
#pragma unroll
    for (int a = 0; a < 2; ++a)
#pragma unroll
        for (int b = 0; b < 2; ++b)
#pragma unroll
            for (int m = 0; m < 4; ++m)
#pragma unroll
                for (int n = 0; n < 2; ++n) acc[a][b][m][n] = (f32x4){0.f, 0.f, 0.f, 0.f};
    bf16x8 At[4][2], B0[2][2], B1[2][2];
    const char* cA = (const char*)g.A + (size_t)cur.pm * tstep; const char* cB = (const char*)g.Bt + (size_t)cur.pn * tstep;
    S.a_ready(cur);
    if constexpr (SP2) {
        PG8_STAGE(PG8_SB(0, 0), cB, voffB); PG8_STAGE(PG8_SB(0, 1), cB + hstep, voffB); PG8_STAGE(PG8_SA(0, 0), cA, voffA); PG8_STAGE(PG8_SA(0, 1), cA + hstep, voffA);
        if (wr == 1) PG8_BAR;
        PG8_WAIT_V(2); PG8_BAR;
        PG8_STAGE(PG8_SB(1, 0), cB + kstep, voffB); PG8_STAGE(PG8_SA(1, 0), cA + kstep, voffA); PG8_STAGE(PG8_SB(1, 1), cB + hstep + kstep, voffB);
        PG8_WAIT_V(6); PG8_BAR;
    } else {
        PG8_STAGE(PG8_SB(0, 0), cB, voffB); PG8_STAGE(PG8_SA(0, 0), cA, voffA); PG8_STAGE(PG8_SB(0, 1), cB + hstep, voffB); PG8_STAGE(PG8_SA(0, 1), cA + hstep, voffA);
        if (wr == 1) PG8_BAR;
        PG8_WAIT_V(4); PG8_BAR;
        PG8_STAGE(PG8_SB(1, 0), cB + kstep, voffB); PG8_STAGE(PG8_SA(1, 0), cA + kstep, voffA); PG8_STAGE(PG8_SB(1, 1), cB + hstep + kstep, voffB);
        PG8_WAIT_V(6); PG8_BAR;
    }
    for (;;) {
        const bool has_next = S.next(ui + 1, nxt);
        const char* nA = has_next ? (const char*)g.A + (size_t)nxt.pm * tstep : cA; const char* nB = has_next ? (const char*)g.Bt + (size_t)nxt.pn * tstep : cB;
        for (int t = 0; t < nt; t += 2) {
            const bool last = (t == nt - 2);
            const char* a1 = cA + (size_t)(t + 1) * kstep;
            const char* a2 = last ? nA : cA + (size_t)(t + 2) * kstep; const char* b2 = last ? nB : cB + (size_t)(t + 2) * kstep;
            const char* a3 = a2 + kstep; const char* b3 = b2 + kstep;
            if (last && has_next) S.a_ready(nxt);
            if constexpr (SP2) {
            PG8_LDB(B0, 0, 0); PG8_LDB(B1, 0, 1); PG8_SCHED; PG8_LDA(At, 0, 0); PG8_STAGE(PG8_SA(1, 1), a1 + hstep, voffA);
            PG8_WAIT_V(8); PG8_WAIT_L(0); PG8_BAR; PG8_MMA(0, 0, At, B0); PG8_MMA(0, 1, At, B1); PG8_BAR; PG8_SCHED;
            PG8_LDA(At, 0, 1); PG8_STAGE(PG8_SB(0, 0), b2, voffB); PG8_STAGE(PG8_SB(0, 1), b2 + hstep, voffB); PG8_STAGE(PG8_SA(0, 0), a2, voffA);
            PG8_WAIT_V(8); PG8_WAIT_L(0); PG8_BAR; PG8_MMA(1, 0, At, B0); PG8_MMA(1, 1, At, B1); PG8_BAR; PG8_SCHED;
            PG8_LDB(B0, 1, 0); PG8_LDB(B1, 1, 1); PG8_SCHED; PG8_LDA(At, 1, 0); PG8_STAGE(PG8_SA(0, 1), a2 + hstep, voffA);
            PG8_WAIT_V(8); PG8_WAIT_L(0); PG8_BAR; PG8_MMA(0, 0, At, B0); PG8_MMA(0, 1, At, B1); PG8_BAR; PG8_SCHED;
            PG8_LDA(At, 1, 1); PG8_STAGE(PG8_SB(1, 0), b3, voffB); PG8_STAGE(PG8_SB(1, 1), b3 + hstep, voffB); PG8_STAGE(PG8_SA(1, 0), a3, voffA);
            PG8_WAIT_V(8); PG8_WAIT_L(0); PG8_BAR; PG8_MMA(1, 0, At, B0); PG8_MMA(1, 1, At, B1); PG8_BAR; PG8_SCHED;
            } else {
            PG8_LDB(B0, 0, 0); PG8_SCHED; PG8_LDA(At, 0, 0); PG8_STAGE(PG8_SA(1, 1), a1 + hstep, voffA);
            PG8_WAIT_L(8); PG8_BAR; PG8_WAIT_L(0); PG8_MMA(0, 0, At, B0); PG8_BAR; PG8_SCHED;
            PG8_LDB(B1, 0, 1); PG8_STAGE(PG8_SB(0, 0), b2, voffB);
            PG8_BAR; PG8_WAIT_L(0); PG8_MMA(0, 1, At, B1); PG8_BAR;
            PG8_LDA(At, 0, 1); PG8_STAGE(PG8_SA(0, 0), a2, voffA);
            PG8_BAR; PG8_WAIT_L(0); PG8_MMA(1, 0, At, B0); PG8_BAR; PG8_SCHED;
            PG8_STAGE(PG8_SB(0, 1), b2 + hstep, voffB);
            PG8_WAIT_V(6); PG8_BAR; PG8_MMA(1, 1, At, B1); PG8_BAR;
            PG8_LDB(B0, 1, 0); PG8_SCHED; PG8_LDA(At, 1, 0); PG8_STAGE(PG8_SA(0, 1), a2 + hstep, voffA);
            PG8_WAIT_L(8); PG8_BAR; PG8_WAIT_L(0); PG8_MMA(0, 0, At, B0); PG8_BAR; PG8_SCHED;
            PG8_LDB(B1, 1, 1); PG8_STAGE(PG8_SB(1, 0), b3, voffB);
            PG8_BAR; PG8_WAIT_L(0); PG8_MMA(0, 1, At, B1); PG8_BAR;
            PG8_LDA(At, 1, 1); PG8_STAGE(PG8_SA(1, 0), a3, voffA);
            PG8_BAR; PG8_WAIT_L(0); PG8_MMA(1, 0, At, B0); PG8_BAR; PG8_SCHED;
            PG8_STAGE(PG8_SB(1, 1), b3 + hstep, voffB);
            PG8_WAIT_V(6); PG8_BAR; PG8_MMA(1, 1, At, B1); PG8_BAR;
            }
        }
        if constexpr (ALIGN_EPI) { if (wr == 0) PG8_BAR; }
        if constexpr (!Epi::AFTER_DRAIN) { E(acc, cur, wr, wc, fr, fq); S.done(cur); }
        if (!has_next) break;
#pragma unroll
        for (int a = 0; a < 2; ++a)
#pragma unroll
            for (int b = 0; b < 2; ++b)
#pragma unroll
                for (int m = 0; m < 4; ++m)
#pragma unroll
                    for (int n = 0; n < 2; ++n) acc[a][b][m][n] = (f32x4){0.f, 0.f, 0.f, 0.f};
        cur = nxt; cA = nA; cB = nB; ++ui;
        if constexpr (ALIGN_EPI) { if (wr == 1) PG8_BAR; }
    }
    PG8_WAIT_V(0);
    if constexpr (!ALIGN_EPI) { if (wr == 0) PG8_BAR; }
    PG8_BAR;
    if constexpr (Epi::AFTER_DRAIN) { E.fused(acc, cur, wr, wc, fr, fq, lds, wid, lane); S.done(cur); }
#undef PG8_SA
#undef PG8_SB
#undef PG8_STAGE
#undef PG8_LDA
#undef PG8_LDB
#undef PG8_MMA
#undef PG8_WAIT_V
#undef PG8_WAIT_L
#undef PG8_BAR
#undef PG8_SCHED
}
}
typedef unsigned short bf16_t;
#define LAS __attribute__((address_space(3)))
typedef short bf16x8 __attribute__((ext_vector_type(8)));
typedef float f32x4 __attribute__((ext_vector_type(4)));
typedef unsigned u32x4 __attribute__((ext_vector_type(4)));
typedef unsigned u32x2 __attribute__((ext_vector_type(2)));
typedef float f32x2v __attribute__((ext_vector_type(2)));

constexpr int S = 16384, DM = 2048, INW = 4096, BW = 1536, NH = 12, NBLK = 64, NLIST = NH * 63;
constexpr int LIST_PER_HEAD = 256 * 2016;
constexpr float ALPHA = 1.6817928305074290f;
constexpr float LN_EPS = 1e-5f;
constexpr size_t MiB = (size_t)1 << 20;
constexpr size_t WS_CTL = 0, WS_HB = 1 * MiB, WS_U = 65 * MiB, WS_KB = 193 * MiB, WS_VB = 241 * MiB, WS_PART = 289 * MiB,
                 WS_WIN = 433 * MiB, WS_WOUT = 449 * MiB, WS_WKV = 457 * MiB, WS_MEMB = 469 * MiB, WS_MKV = 470 * MiB, WS_ML = 472 * MiB,
                 WS_KMEAN = 477 * MiB, WS_SEL = 478 * MiB, WS_LISTS = 479 * MiB, WS_END = 491 * MiB;
constexpr size_t WS_POOLED = WS_PART, WS_WPOOL = WS_PART + 64 * MiB, WS_WMKV = WS_PART + 80 * MiB;
constexpr int LDS_BYTES = 131072 + 4096;

__device__ __forceinline__ float bf2f(bf16_t b) { return __uint_as_float(((unsigned)b) << 16); }
__device__ __forceinline__ unsigned pk2(float lo, float hi) { return pg8::cvt_pk_bf16(lo, hi); }
__device__ __forceinline__ bf16_t f2bf(float f) { return (bf16_t)(pg8::cvt_pk_bf16(f, 0.f) & 0xffffu); }
__device__ __forceinline__ float silu(float x) { return x * __builtin_amdgcn_rcpf(1.0f + __expf(-x)); }
__device__ __forceinline__ float wave_sum(float v) {
#pragma unroll
    for (int o = 1; o < 64; o <<= 1) v += __shfl_xor(v, o);
    return v;
}
#define LDS_WAIT() asm volatile("s_waitcnt lgkmcnt(0)" ::: "memory")
#define PH_VARS() const int tid = pg8::opaque_tid(), lane = tid & 63, wid = __builtin_amdgcn_readfirstlane(tid >> 6); const int gw = blockIdx.x * 8 + wid; const size_t gtid = (size_t)blockIdx.x * 512 + tid; LAS float* scr = (LAS float*)(ldsl + wid * 16384); (void)lane; (void)gw; (void)gtid; (void)scr

struct EpiBf16 {
    static constexpr bool PERM = true, AFTER_DRAIN = false;
    bf16_t* O; int ldc; int split_cols; size_t split_stride;
    __device__ __forceinline__ void operator()(const f32x4 (&acc)[2][2][4][2], const pg8::Unit& u, int wr, int wc, int fr, int fq) const {
        const int row0 = u.pm * 256 + wr * 64 + fr; int colt = u.pn * 256; bf16_t* base = O;
        if (split_cols) { const int t = colt / split_cols; base += (size_t)t * split_stride; colt -= t * split_cols; }
        const int col0 = colt + wc * 32 + 8 * fq;
#pragma unroll
        for (int ai = 0; ai < 2; ++ai)
#pragma unroll
            for (int m = 0; m < 4; ++m) { bf16_t* rowp = base + (size_t)(row0 + ai * 128 + m * 16) * ldc + col0;
#pragma unroll
                for (int bj = 0; bj < 2; ++bj) { const f32x4 v0 = acc[ai][bj][m][0], v1 = acc[ai][bj][m][1];
                    u32x4 w; w.x = pk2(v0[0], v0[1]); w.y = pk2(v0[2], v0[3]); w.z = pk2(v1[0], v1[1]); w.w = pk2(v1[2], v1[3]);
                    *(u32x4*)(rowp + bj * 128) = w; } }
    }
};
struct EpiPool {
    static constexpr bool PERM = true, AFTER_DRAIN = false;
    bf16_t* O; const bf16_t* U; const float* scale;
    __device__ __forceinline__ void operator()(const f32x4 (&acc)[2][2][4][2], const pg8::Unit& u, int wr, int wc, int fr, int fq) const {
        const int row0 = u.pm * 256 + wr * 64 + fr; const int col0 = u.pn * 256 + wc * 32 + 8 * fq;
#pragma unroll
        for (int bj = 0; bj < 2; ++bj) {
            const f32x4 s0 = *(const f32x4*)(scale + col0 + bj * 128), s1 = *(const f32x4*)(scale + col0 + bj * 128 + 4);
#pragma unroll
            for (int ai = 0; ai < 2; ++ai)
#pragma unroll
                for (int m = 0; m < 4; ++m) { const int row = row0 + ai * 128 + m * 16;
                    const u32x4 g = *(const u32x4*)(U + (size_t)row * INW + BW + col0 + bj * 128);
                    const f32x4 v0 = acc[ai][bj][m][0] * s0, v1 = acc[ai][bj][m][1] * s1;
                    float r[8];
                    r[0] = v0[0] * silu(__uint_as_float(g.x << 16)); r[1] = v0[1] * silu(__uint_as_float(g.x & 0xffff0000u));
                    r[2] = v0[2] * silu(__uint_as_float(g.y << 16)); r[3] = v0[3] * silu(__uint_as_float(g.y & 0xffff0000u));
                    r[4] = v1[0] * silu(__uint_as_float(g.z << 16)); r[5] = v1[1] * silu(__uint_as_float(g.z & 0xffff0000u));
                    r[6] = v1[2] * silu(__uint_as_float(g.w << 16)); r[7] = v1[3] * silu(__uint_as_float(g.w & 0xffff0000u));
                    u32x4 w; w.x = pk2(r[0], r[1]); w.y = pk2(r[2], r[3]); w.z = pk2(r[4], r[5]); w.w = pk2(r[6], r[7]);
                    *(u32x4*)(O + (size_t)row * DM + col0 + bj * 128) = w; }
        }
    }
};
struct EpiRes {
    static constexpr bool PERM = false, AFTER_DRAIN = false;
    const float* base; float* C;
    __device__ __forceinline__ void operator()(const f32x4 (&acc)[2][2][4][2], const pg8::Unit& u, int wr, int wc, int fr, int fq) const {
        const int row0 = u.pm * 256 + wr * 64 + fr, col0 = u.pn * 256 + wc * 32 + 4 * fq;
#pragma unroll
        for (int ai = 0; ai < 2; ++ai)
#pragma unroll
            for (int m = 0; m < 4; ++m) { const size_t off = (size_t)(row0 + ai * 128 + m * 16) * DM + col0;
#pragma unroll
                for (int bj = 0; bj < 2; ++bj)
#pragma unroll
                    for (int n = 0; n < 2; ++n) { const f32x4 b = *(const f32x4*)(base + off + bj * 128 + n * 16);
                        *(f32x4*)(C + off + bj * 128 + n * 16) = b * ALPHA + acc[ai][bj][m][n]; } }
    }
};

__device__ __forceinline__ void transpose_item(const float* W, int ldw, bf16_t* WT, int ldt, int k0, int n0, LAS float* scr, int lane) {
#pragma unroll 8
    for (int i = 0; i < 32; ++i) { const int kk = 2 * i + (lane >> 5); scr[kk * 33 + (lane & 31)] = W[(size_t)(k0 + kk) * ldw + n0 + (lane & 31)]; }
    LDS_WAIT();
    const int c = lane & 7;
#pragma unroll
    for (int j = 0; j < 4; ++j) { const int n = (lane >> 3) + 8 * j; const LAS float* s = scr + (8 * c) * 33 + n;
        u32x4 o; o.x = pk2(s[0 * 33], s[1 * 33]); o.y = pk2(s[2 * 33], s[3 * 33]); o.z = pk2(s[4 * 33], s[5 * 33]); o.w = pk2(s[6 * 33], s[7 * 33]);
        *(u32x4*)(WT + (size_t)(n0 + n) * ldt + k0 + 8 * c) = o; }
    LDS_WAIT();
}
__device__ __forceinline__ void transpose_matrix(const float* W, int K, int N, int ldw, bf16_t* WT, int ldt, LAS float* scr, int gw, int NGW, int lane) {
    const int nNb = N / 32, nit = (K / 64) * nNb;
    for (int it = gw; it < nit; it += NGW) { const int kb = it / nNb, nb = it - kb * nNb; transpose_item(W, ldw, WT, ldt, kb * 64, nb * 32, scr, lane); }
}
__device__ __forceinline__ void cvt_rows(const float* src, bf16_t* dst, size_t n8, size_t gtid, size_t nthr) {
    for (size_t i = gtid; i < n8; i += nthr) { const f32x4 a = *(const f32x4*)(src + i * 8), b = *(const f32x4*)(src + i * 8 + 4);
        u32x4 w; w.x = pk2(a[0], a[1]); w.y = pk2(a[2], a[3]); w.z = pk2(b[0], b[1]); w.w = pk2(b[2], b[3]); *(u32x4*)(dst + i * 8) = w; }
}

__device__ __forceinline__ void memkv_gemm(const bf16_t* A, const bf16_t* Bt, bf16_t* out, int wid, int lane) {
    for (int tile = blockIdx.x; tile < 256; tile += gridDim.x) {
        const int tm = tile & 3, tn = tile >> 2;
        const int row0 = tm * 64 + (wid & 3) * 16, col0 = tn * 64 + (wid >> 2) * 32;
        const bf16_t* ap = A + (size_t)(row0 + (lane & 15)) * DM + (lane >> 4) * 8;
        const bf16_t* b0p = Bt + (size_t)(col0 + (lane & 15)) * DM + (lane >> 4) * 8;
        const bf16_t* b1p = b0p + (size_t)16 * DM;
        f32x4 acc0 = {0.f, 0.f, 0.f, 0.f}, acc1 = {0.f, 0.f, 0.f, 0.f};
#pragma unroll 4
        for (int k = 0; k < DM; k += 32) {
            const bf16x8 a = *(const bf16x8*)(ap + k), b0 = *(const bf16x8*)(b0p + k), b1 = *(const bf16x8*)(b1p + k);
            acc0 = __builtin_amdgcn_mfma_f32_16x16x32_bf16(a, b0, acc0, 0, 0, 0);
            acc1 = __builtin_amdgcn_mfma_f32_16x16x32_bf16(a, b1, acc1, 0, 0, 0);
        }
#pragma unroll
        for (int r = 0; r < 4; ++r) { const int row = row0 + (lane >> 4) * 4 + r; const int c = col0 + (lane & 15);
            const int layer = c >> 10, cc = c & 1023;
            bf16_t* o = out + (size_t)layer * 256 * 1024 + (size_t)row * 1024 + cc;
            o[0] = f2bf(acc0[r]); o[16] = f2bf(acc1[r]); }
    }
}

namespace att {
using s16x4  = __attribute__((ext_vector_type(4))) short;
using f32x16 = __attribute__((ext_vector_type(16))) float;
constexpr int KVBLK = 64;
constexpr float SCALE = 0.088388347648318440f, THR = 8.f;
constexpr int SHM_V = 16384, SHM_K = 16384, WS_OFF = 65536;
#define KSWZ(row, colB) ((row) * 256 + ((colB) ^ (((row) & 7) << 4)))
#define SBAR() __builtin_amdgcn_sched_barrier(0)
__device__ __forceinline__ int crow(int r, int hi) { return (r & 3) + 8 * (r >> 2) + 4 * hi; }
__device__ __forceinline__ unsigned cvtpk(float lo, float hi) { return pg8::cvt_pk_bf16(lo, hi); }

__device__ __forceinline__ void partialSM(f32x16& p0, f32x16& p1, float& m_reg, float& mn, float& alpha) {
  constexpr float C = SCALE * 1.4426950408889634f;
  float pmax = p0[0];
#pragma unroll
  for (int r = 1; r < 16; ++r) pmax = fmaxf(pmax, p0[r]);
#pragma unroll
  for (int r = 0; r < 16; ++r) pmax = fmaxf(pmax, p1[r]);
  { auto rr = __builtin_amdgcn_permlane32_swap(__float_as_uint(pmax), __float_as_uint(pmax), false, false);
    pmax = fmaxf(__uint_as_float(rr[0]), __uint_as_float(rr[1])); }
  if (__builtin_expect(__all(pmax - m_reg <= THR / SCALE), 1)) { mn = m_reg; alpha = 1.f; }
  else { mn = fmaxf(m_reg, pmax); alpha = __builtin_amdgcn_exp2f((m_reg - mn) * C); m_reg = mn; }
  float mnC = -mn * C;
#pragma unroll
  for (int r = 0; r < 16; ++r) p0[r] = fmaf(p0[r], C, mnC);
#pragma unroll
  for (int r = 0; r < 16; ++r) p1[r] = fmaf(p1[r], C, mnC);
#pragma unroll
  for (int r = 0; r < 16; ++r) p0[r] = __builtin_amdgcn_exp2f(p0[r]);
}
__device__ __forceinline__ void finishSM(f32x16& p0, f32x16& p1, float alpha, float& l_reg, bf16x8& pa0, bf16x8& pa1, bf16x8& pa2, bf16x8& pa3) {
#pragma unroll
  for (int r = 0; r < 16; ++r) p1[r] = __builtin_amdgcn_exp2f(p1[r]);
  float ps = 0;
#pragma unroll
  for (int r = 0; r < 16; ++r) ps += p0[r];
#pragma unroll
  for (int r = 0; r < 16; ++r) ps += p1[r];
  { auto rr = __builtin_amdgcn_permlane32_swap(__float_as_uint(ps), __float_as_uint(ps), false, false);
    ps = __uint_as_float(rr[0]) + __uint_as_float(rr[1]); }
  l_reg = l_reg * alpha + ps;
#define PK4(P, BASE, OUT) do { unsigned a0 = cvtpk(P[BASE + 0], P[BASE + 1]), a1 = cvtpk(P[BASE + 2], P[BASE + 3]);   \
    unsigned b0 = cvtpk(P[BASE + 4], P[BASE + 5]), b1 = cvtpk(P[BASE + 6], P[BASE + 7]);                              \
    auto r0 = __builtin_amdgcn_permlane32_swap(a0, b0, false, false); auto r1 = __builtin_amdgcn_permlane32_swap(a1, b1, false, false); \
    u32x4 w = {r0[0], r1[0], r0[1], r1[1]}; OUT = *reinterpret_cast<bf16x8*>(&w); } while (0)
  PK4(p0, 0, pa0); PK4(p0, 8, pa1); PK4(p1, 0, pa2); PK4(p1, 8, pa3);
#undef PK4
}
__device__ __forceinline__ void qkt(f32x16& p0, f32x16& p1, const char* Ks, const bf16x8* qr, int r32, int hi) {
  p0 = f32x16{}; p1 = f32x16{};
#pragma unroll
  for (int d0 = 0; d0 < 8; ++d0) { int cb = (d0 * 16 + hi * 8) * 2;
    bf16x8 b0 = *reinterpret_cast<const bf16x8*>(Ks + KSWZ(r32, cb));
    bf16x8 b1 = *reinterpret_cast<const bf16x8*>(Ks + KSWZ(32 + r32, cb));
    p0 = __builtin_amdgcn_mfma_f32_32x32x16_bf16(b0, qr[d0], p0, 0, 0, 0);
    p1 = __builtin_amdgcn_mfma_f32_32x32x16_bf16(b1, qr[d0], p1, 0, 0, 0); }
}
__device__ __forceinline__ void mask_tile(f32x16& p0, f32x16& p1, int kq, int hi) {
#pragma unroll
  for (int r = 0; r < 16; ++r) { const int k = crow(r, hi); if (k > kq) p0[r] = -__builtin_inff(); if (k + 32 > kq) p1[r] = -__builtin_inff(); }
}
__device__ __forceinline__ int v_st(int k, int c) { const int kk = (k & ~0xC) | ((k & 4) << 1) | ((k & 8) >> 1); return ((kk >> 3) * 4 + (c >> 5)) * 512 + ((kk & 7) * 32 + (c & 31)) * 2; }
__device__ __forceinline__ int v_rd_base(int lane) { return ((lane & 3) << 3) | (((lane >> 2) & 3) << 6) | (((lane >> 4) & 1) << 5) | (((lane >> 5) & 1) << 8); }
constexpr int v_rd_off(int d0, int ks, int half) { return d0 * 512 + ks * 4096 + half * 2048; }
template <int OFF> __device__ __forceinline__ s16x4 tr_read(int vb) {
  s16x4 r; asm volatile("ds_read_b64_tr_b16 %0, %1 offset:%2" : "=&v"(r) : "v"(vb), "i"(OFF) : "memory"); return r;
}
template <int D0> __device__ __forceinline__ void pv_one(f32x16& od, int vb, bf16x8 pa0, bf16x8 pa1, bf16x8 pa2, bf16x8 pa3) {
  const s16x4 l0 = tr_read<v_rd_off(D0, 0, 0)>(vb), h0 = tr_read<v_rd_off(D0, 0, 1)>(vb), l1 = tr_read<v_rd_off(D0, 1, 0)>(vb), h1 = tr_read<v_rd_off(D0, 1, 1)>(vb);
  const s16x4 l2 = tr_read<v_rd_off(D0, 2, 0)>(vb), h2 = tr_read<v_rd_off(D0, 2, 1)>(vb), l3 = tr_read<v_rd_off(D0, 3, 0)>(vb), h3 = tr_read<v_rd_off(D0, 3, 1)>(vb);
  asm volatile("s_waitcnt lgkmcnt(0)" ::: "memory"); SBAR();
#define PK(L, H) (bf16x8){L[0], L[1], L[2], L[3], H[0], H[1], H[2], H[3]}
  od = __builtin_amdgcn_mfma_f32_32x32x16_bf16(pa0, PK(l0, h0), od, 0, 0, 0);
  od = __builtin_amdgcn_mfma_f32_32x32x16_bf16(pa1, PK(l1, h1), od, 0, 0, 0);
  od = __builtin_amdgcn_mfma_f32_32x32x16_bf16(pa2, PK(l2, h2), od, 0, 0, 0);
  od = __builtin_amdgcn_mfma_f32_32x32x16_bf16(pa3, PK(l3, h3), od, 0, 0, 0);
#undef PK
}
__device__ __forceinline__ void pv_d0(f32x16* o, int vb, bf16x8 pa0, bf16x8 pa1, bf16x8 pa2, bf16x8 pa3) {
  pv_one<0>(o[0], vb, pa0, pa1, pa2, pa3); pv_one<1>(o[1], vb, pa0, pa1, pa2, pa3); pv_one<2>(o[2], vb, pa0, pa1, pa2, pa3); pv_one<3>(o[3], vb, pa0, pa1, pa2, pa3);
}

struct Out {
  const bf16_t* U; bf16_t* MIX; int t0; int head;
  bf16_t* PART; f32x2v* ML; int ent;
  int nvalid;
};

template <int MODE>
__device__ __forceinline__ void attn_unit(const bf16_t* __restrict__ Qrow, const bf16_t* __restrict__ Kh, const bf16_t* __restrict__ Vh, const int ldk, char* lds, const Out& ot) {
  const int tid = pg8::opaque_tid(), wid = tid >> 6, lane = tid & 63, r32 = lane & 31, hi = lane >> 5;
  char* V_lds = lds; char* K_lds = lds + 2 * SHM_V;
  float* ws = (float*)(lds + WS_OFF) + wid * 256; float* li_l = ws; float* al_l = ws + 32; int* tab = (int*)(ws + 64); float* coef = ws + 96;
  float m_reg = -1e30f, l_reg = 0; f32x16 o[4] = {}; bf16x8 qr[8];
  const bf16_t* Qw = Qrow + hi * 8;
#pragma unroll
  for (int d0 = 0; d0 < 8; ++d0) qr[d0] = *reinterpret_cast<const bf16x8*>(Qw + d0 * 16);
  const int sr = tid >> 4, sc = (tid & 15) * 8, vst0 = v_st(sr, sc), vst1 = v_st(32 + sr, sc);
  const int vb0 = (int)(uintptr_t)V_lds + v_rd_base(lane);
  const int kq0 = wid * 32 + r32;
  struct { bf16x8 vs0, vs1, ks0, ks1; } sr_[2];
#define SLOAD(i, k0) do { sr_[i].vs0 = *(const bf16x8*)(&Vh[(long)((k0) + sr) * ldk + sc]); sr_[i].vs1 = *(const bf16x8*)(&Vh[(long)((k0) + 32 + sr) * ldk + sc]); \
    sr_[i].ks0 = *(const bf16x8*)(&Kh[(long)((k0) + sr) * ldk + sc]); sr_[i].ks1 = *(const bf16x8*)(&Kh[(long)((k0) + 32 + sr) * ldk + sc]); } while (0)
#define SWRITE(b, i) do { *(bf16x8*)(V_lds + (b) * SHM_V + vst0) = sr_[i].vs0;          \
    *(bf16x8*)(V_lds + (b) * SHM_V + vst1) = sr_[i].vs1; int kc = sc * 2;               \
    *(bf16x8*)(K_lds + (b) * SHM_K + KSWZ(sr, kc)) = sr_[i].ks0;                       \
    *(bf16x8*)(K_lds + (b) * SHM_K + KSWZ(32 + sr, kc)) = sr_[i].ks1; } while (0)
#define SWAIT() asm volatile("s_waitcnt vmcnt(4)" ::: "memory")
#define RESC(a) do { if (__any((a) < 1.f)) { if (hi == 0) al_l[r32] = (a); asm volatile("s_waitcnt lgkmcnt(0)" ::: "memory"); \
    _Pragma("unroll") for (int d = 0; d < 4; ++d) _Pragma("unroll") for (int r = 0; r < 16; ++r) o[d][r] *= al_l[crow(r, hi)]; } } while (0)
  f32x16 pA0, pA1, pB0, pB1; float mnA, mnB, alA, alB; bf16x8 pa0, pa1, pa2, pa3;
  SLOAD(0, 0); asm volatile("s_waitcnt vmcnt(0)" ::: "memory"); SWRITE(0, 0); __syncthreads();
  qkt(pA0, pA1, K_lds, qr, r32, hi); if (MODE == 2) mask_tile(pA0, pA1, kq0, hi); partialSM(pA0, pA1, m_reg, mnA, alA);
  SLOAD(1, KVBLK); SLOAD(0, 2 * KVBLK);
  SWAIT(); SWRITE(1, 1); __syncthreads();
  {
    SBAR(); qkt(pB0, pB1, K_lds + SHM_K, qr, r32, hi); if (MODE == 2) mask_tile(pB0, pB1, kq0 - 64, hi);
    finishSM(pA0, pA1, alA, l_reg, pa0, pa1, pa2, pa3); SBAR();
    SLOAD(1, 3 * KVBLK); SBAR();
    pv_d0(o, vb0, pa0, pa1, pa2, pa3); partialSM(pB0, pB1, m_reg, mnB, alB);
    __syncthreads(); SWAIT(); SWRITE(0, 0);
    RESC(alB); __syncthreads();
    SBAR(); qkt(pA0, pA1, K_lds, qr, r32, hi); if (MODE == 2) mask_tile(pA0, pA1, kq0 - 128, hi);
    finishSM(pB0, pB1, alB, l_reg, pa0, pa1, pa2, pa3); SBAR();
    pv_d0(o, vb0 + SHM_V, pa0, pa1, pa2, pa3); partialSM(pA0, pA1, m_reg, mnA, alA);
    __syncthreads(); asm volatile("s_waitcnt vmcnt(0)" ::: "memory"); SWRITE(1, 1);
    RESC(alA); __syncthreads();
  }
  SBAR(); qkt(pB0, pB1, K_lds + SHM_K, qr, r32, hi); if (MODE == 2) mask_tile(pB0, pB1, kq0 - 192, hi);
  finishSM(pA0, pA1, alA, l_reg, pa0, pa1, pa2, pa3); SBAR();
  pv_d0(o, vb0, pa0, pa1, pa2, pa3); partialSM(pB0, pB1, m_reg, mnB, alB);
  __syncthreads(); RESC(alB);
  finishSM(pB0, pB1, alB, l_reg, pa0, pa1, pa2, pa3); SBAR();
  pv_d0(o, vb0 + SHM_V, pa0, pa1, pa2, pa3);
#undef SLOAD
#undef SWRITE
#undef SWAIT
#undef RESC
  if (MODE == 0) {
    if (hi == 0) li_l[r32] = l_reg;
    asm volatile("s_waitcnt lgkmcnt(0)" ::: "memory");
#pragma unroll
    for (int r = 0; r < 16; ++r) { const int row = crow(r, hi); const float rl = __builtin_amdgcn_rcpf(li_l[row]); const size_t t = (size_t)(ot.t0 + wid * 32 + row);
      const bf16_t* gp = ot.U + t * INW + 3584 + ot.head * 128 + r32; bf16_t* op = ot.MIX + t * DM + BW + ot.head * 128 + r32;
#pragma unroll
      for (int d0 = 0; d0 < 4; ++d0) op[d0 * 32] = f2bf(o[d0][r] * rl * silu(bf2f(gp[d0 * 32]))); }
  } else if (MODE == 1) {
    if (hi == 0) { li_l[r32] = l_reg; tab[r32] = ot.ent;
      if (ot.ent >= 0) { const int q = ot.ent >> 2, slot = ot.ent & 3; ot.ML[((size_t)slot * S + q) * NH + ot.head] = (f32x2v){m_reg * SCALE, l_reg}; } }
    asm volatile("s_waitcnt lgkmcnt(0)" ::: "memory");
#pragma unroll
    for (int r = 0; r < 16; ++r) { const int row = crow(r, hi); const int e = tab[row]; const float rl = __builtin_amdgcn_rcpf(li_l[row]);
      if (e >= 0) { const int q = e >> 2, slot = e & 3; bf16_t* op = ot.PART + ((size_t)slot * S + q) * BW + ot.head * 128 + r32;
#pragma unroll
        for (int d0 = 0; d0 < 4; ++d0) op[d0 * 32] = f2bf(o[d0][r] * rl); } }
  } else {
    if (hi == 0) { const size_t t = (size_t)(ot.t0 + wid * 32 + r32); const float mo = m_reg * SCALE; float ms[3], ls[3]; float M = mo;
#pragma unroll
      for (int s = 0; s < 3; ++s) { if (s < ot.nvalid) { const f32x2v v = ot.ML[((size_t)s * S + t) * NH + ot.head]; ms[s] = v.x; ls[s] = v.y; M = fmaxf(M, v.x); } else { ms[s] = 0.f; ls[s] = 0.f; } }
      const float eo = __expf(mo - M); float W = l_reg * eo; float w[3];
#pragma unroll
      for (int s = 0; s < 3; ++s) { w[s] = (s < ot.nvalid) ? ls[s] * __expf(ms[s] - M) : 0.f; W += w[s]; }
      const float inv = 1.0f / W;
      *(f32x4*)(coef + r32 * 4) = (f32x4){eo * inv, w[0] * inv, w[1] * inv, w[2] * inv}; }
    asm volatile("s_waitcnt lgkmcnt(0)" ::: "memory");
#pragma unroll
    for (int r = 0; r < 16; ++r) { const int row = crow(r, hi); const size_t t = (size_t)(ot.t0 + wid * 32 + row); const f32x4 c = *(const f32x4*)(coef + row * 4);
      const int col = ot.head * 128 + r32;
      const bf16_t* gp = ot.U + t * INW + BW + col; bf16_t* op = ot.MIX + t * DM + col; const bf16_t* pp = ot.PART + t * BW + col;
#pragma unroll
      for (int d0 = 0; d0 < 4; ++d0) { float v = o[d0][r] * c[0];
        if (ot.nvalid > 0) v += c[1] * bf2f(pp[d0 * 32]);
        if (ot.nvalid > 1) v += c[2] * bf2f(pp[(size_t)S * BW + d0 * 32]);
        if (ot.nvalid > 2) v += c[3] * bf2f(pp[(size_t)2 * S * BW + d0 * 32]);
        op[d0 * 32] = f2bf(v * silu(bf2f(gp[d0 * 32]))); } }
  }
}
}

struct Top3 { float v0, v1, v2; int i0, i1, i2; };
__device__ __forceinline__ bool t3_better(float a, int ia, float b, int ib) { return a > b || (a == b && ia < ib); }
__device__ __forceinline__ void t3_ins(Top3& t, float v, int i) {
    if (t3_better(v, i, t.v2, t.i2)) {
        if (t3_better(v, i, t.v1, t.i1)) { t.v2 = t.v1; t.i2 = t.i1;
            if (t3_better(v, i, t.v0, t.i0)) { t.v1 = t.v0; t.i1 = t.i0; t.v0 = v; t.i0 = i; } else { t.v1 = v; t.i1 = i; } }
        else { t.v2 = v; t.i2 = i; } }
}
__device__ __forceinline__ void gate_phase(const bf16_t* U, const bf16_t* KMH, const bf16_t* KML, unsigned* SEL, int gw, int NGW, int lane) {
    const float NINF = -__builtin_inff();
    for (int it = gw; it < NH * (S / 16); it += NGW) {
        const int h = it / (S / 16), qt = it - h * (S / 16), q0 = qt * 16, own = q0 >> 8;
        if (own == 0) { if (lane < 16) SEL[(size_t)h * S + q0 + lane] = 0x00ffffffu; continue; }
        const bf16_t* qp = U + (size_t)(q0 + (lane & 15)) * INW + h * 128 + (lane >> 4) * 8;
        bf16x8 bq[4];
#pragma unroll
        for (int ks = 0; ks < 4; ++ks) bq[ks] = *(const bf16x8*)(qp + ks * 32);
        const int nmt = (own + 15) >> 4;
        f32x4 acc[4];
#pragma unroll
        for (int mt = 0; mt < 4; ++mt) { acc[mt] = (f32x4){0.f, 0.f, 0.f, 0.f};
            if (mt < nmt) { const size_t ko = ((size_t)(h * NBLK + mt * 16 + (lane & 15))) * 128 + (lane >> 4) * 8;
#pragma unroll
                for (int ks = 0; ks < 4; ++ks) { const bf16x8 ah = *(const bf16x8*)(KMH + ko + ks * 32), al = *(const bf16x8*)(KML + ko + ks * 32);
                    acc[mt] = __builtin_amdgcn_mfma_f32_16x16x32_bf16(ah, bq[ks], acc[mt], 0, 0, 0);
                    acc[mt] = __builtin_amdgcn_mfma_f32_16x16x32_bf16(al, bq[ks], acc[mt], 0, 0, 0); } } }
        Top3 t; t.v0 = NINF; t.v1 = NINF; t.v2 = NINF; t.i0 = 256; t.i1 = 257; t.i2 = 258;
#pragma unroll
        for (int mt = 0; mt < 4; ++mt)
#pragma unroll
            for (int r = 0; r < 4; ++r) { const int blk = mt * 16 + (lane >> 4) * 4 + r; const float v = (blk < own) ? acc[mt][r] : NINF; t3_ins(t, v, blk); }
#pragma unroll
        for (int x = 16; x <= 32; x <<= 1) {
            const float a0 = __shfl_xor(t.v0, x), a1 = __shfl_xor(t.v1, x), a2 = __shfl_xor(t.v2, x);
            const int j0 = __shfl_xor(t.i0, x), j1 = __shfl_xor(t.i1, x), j2 = __shfl_xor(t.i2, x);
            t3_ins(t, a0, j0); t3_ins(t, a1, j1); t3_ins(t, a2, j2);
        }
        if (lane < 16) { const unsigned s0 = (t.v0 == NINF) ? 255u : (unsigned)t.i0, s1 = (t.v1 == NINF) ? 255u : (unsigned)t.i1, s2 = (t.v2 == NINF) ? 255u : (unsigned)t.i2;
            SEL[(size_t)h * S + q0 + lane] = s0 | (s1 << 8) | (s2 << 16); }
    }
}

struct Params { const float *x, *mem, *w_in, *w_out, *w_mkv, *ln_g, *ln_b, *pool_w, *pool_scale, *w_kv; float* out; unsigned char* ws; };

__global__ void __launch_bounds__(512, 2) yoco_fwd(Params p) {
    extern __shared__ __attribute__((aligned(16))) unsigned char lds[];
    cg::grid_group grid = cg::this_grid();
    const int G = gridDim.x, NGW = G * 8; const size_t nthr = (size_t)G * 512;
    unsigned char* ws = p.ws;
#define HB_ ((bf16_t*)(ws + WS_HB))
#define MIX_ ((bf16_t*)(ws + WS_HB))
#define U_ ((bf16_t*)(ws + WS_U))
#define KB_ ((bf16_t*)(ws + WS_KB))
#define VB_ ((bf16_t*)(ws + WS_VB))
#define PART_ ((bf16_t*)(ws + WS_PART))
#define POOLED_ ((bf16_t*)(ws + WS_POOLED))
#define WPOOL_ ((bf16_t*)(ws + WS_WPOOL))
#define WMKV_ ((bf16_t*)(ws + WS_WMKV))
#define WIN_ ((bf16_t*)(ws + WS_WIN))
#define WOUT_ ((bf16_t*)(ws + WS_WOUT))
#define WKV_ ((bf16_t*)(ws + WS_WKV))
#define MEMB_ ((bf16_t*)(ws + WS_MEMB))
#define MKV_ ((bf16_t*)(ws + WS_MKV))
#define ML_ ((f32x2v*)(ws + WS_ML))
#define KMH_ ((bf16_t*)(ws + WS_KMEAN))
#define KML_ (KMH_ + NH * NBLK * 128)
#define SEL_ ((unsigned*)(ws + WS_SEL))
#define LISTS_ ((unsigned short*)(ws + WS_LISTS))
#define CNT_ ((int*)(ws + WS_CTL))
    LAS unsigned char* ldsl = (LAS unsigned char*)lds;
    LAS int* pref = (LAS int*)(ldsl + 131072);

    { PH_VARS();
    cvt_rows(p.x, HB_, (size_t)S * DM / 8, gtid, nthr);
    cvt_rows(p.mem, MEMB_, (size_t)256 * DM / 8, gtid, nthr);
    transpose_matrix(p.w_in, DM, INW, INW, WIN_, DM, scr, gw, NGW, lane);
    transpose_matrix(p.w_out, DM, DM, DM, WOUT_, DM, scr, gw, NGW, lane);
    transpose_matrix(p.w_kv, DM, 2 * BW, 2 * BW, WKV_, DM, scr, gw, NGW, lane);
    for (int l = 0; l < 4; ++l) transpose_matrix(p.w_mkv + (size_t)l * DM * 1024, DM, 1024, 1024, WMKV_ + (size_t)l * 1024 * DM, DM, scr, gw, NGW, lane);
    for (int lg = 0; lg < 8; ++lg) { const int l = lg >> 2, g = lg & 3;
        transpose_matrix(p.pool_w + (size_t)lg * 384 * 384, 384, 384, 384, WPOOL_ + (size_t)l * BW * BW + (size_t)(g * 384) * BW + g * 384, BW, scr, gw, NGW, lane); }
    for (size_t i = gtid; i < (size_t)2 * BW * (BW / 8); i += nthr) {
        const size_t rowi = i / (BW / 8); const int k8 = (int)(i - rowi * (BW / 8)); const int n = (int)(rowi % BW);
        if ((k8 * 8) / 384 != n / 384) *(u32x4*)(WPOOL_ + rowi * BW + k8 * 8) = (u32x4){0u, 0u, 0u, 0u}; }
    }
    grid.sync();

    for (int layer = 0; layer < 4; ++layer) {
        if (layer == 0) { PH_VARS(); memkv_gemm(MEMB_, WMKV_, MKV_, wid, lane); }
        __syncthreads();
        for (int gi = (layer == 2 ? 0 : 1); gi < 2; ++gi) {
            pg8::Gemm g{HB_, gi == 0 ? WKV_ : WIN_, S, gi == 0 ? 2 * BW : INW, DM}; pg8::StaticOrder So; So.init(g.M, g.N, G, (int)blockIdx.x);
            EpiBf16 E{gi == 0 ? KB_ : U_, gi == 0 ? BW : INW, gi == 0 ? BW : 0, (size_t)(WS_VB - WS_KB) / 2};
#ifndef NO_G1
            pg8::gemm_phase<EpiBf16, pg8::StaticOrder, true, true>(ldsl, g, So, E);
#endif
            __syncthreads();
        }
        grid.sync();
        if (layer < 2) {
            PH_VARS();
            for (size_t i = gtid; i < (size_t)S * (BW / 8); i += nthr) {
                const int t = (int)(i / (BW / 8)), v = (int)(i - (size_t)t * (BW / 8)), c = v * 8, gidx = c / 384, w = 2 << gidx;
                const int lo = (t + 1 - w) > 0 ? (t + 1 - w) : 0; const float inv = 1.0f / (float)(t + 1 - lo);
                float s[8] = {0.f, 0.f, 0.f, 0.f, 0.f, 0.f, 0.f, 0.f}; u32x4 x = {0u, 0u, 0u, 0u};
                for (int r = lo; r <= t; ++r) { x = *(const u32x4*)(U_ + (size_t)r * INW + c);
                    s[0] += __uint_as_float(x.x << 16); s[1] += __uint_as_float(x.x & 0xffff0000u); s[2] += __uint_as_float(x.y << 16); s[3] += __uint_as_float(x.y & 0xffff0000u);
                    s[4] += __uint_as_float(x.z << 16); s[5] += __uint_as_float(x.z & 0xffff0000u); s[6] += __uint_as_float(x.w << 16); s[7] += __uint_as_float(x.w & 0xffff0000u); }
                u32x4 o;
                o.x = pk2(s[0] * inv - __uint_as_float(x.x << 16), s[1] * inv - __uint_as_float(x.x & 0xffff0000u));
                o.y = pk2(s[2] * inv - __uint_as_float(x.y << 16), s[3] * inv - __uint_as_float(x.y & 0xffff0000u));
                o.z = pk2(s[4] * inv - __uint_as_float(x.z << 16), s[5] * inv - __uint_as_float(x.z & 0xffff0000u));
                o.w = pk2(s[6] * inv - __uint_as_float(x.w << 16), s[7] * inv - __uint_as_float(x.w & 0xffff0000u));
                *(u32x4*)(POOLED_ + (size_t)t * BW + c) = o;
            }
        } else {
            if (layer == 2) {
                { PH_VARS();
                for (int it = gw; it < NBLK * NH; it += NGW) { const int blk = it / NH, h = it - blk * NH; const int cv = lane & 15, rq = lane >> 4;
                    const bf16_t* kp = KB_ + (size_t)(blk * 256 + rq * 64) * BW + h * 128 + cv * 8; float s[8] = {0.f, 0.f, 0.f, 0.f, 0.f, 0.f, 0.f, 0.f};
#pragma unroll 8
                    for (int r = 0; r < 64; ++r) { const u32x4 x = *(const u32x4*)(kp + (size_t)r * BW);
                        s[0] += __uint_as_float(x.x << 16); s[1] += __uint_as_float(x.x & 0xffff0000u); s[2] += __uint_as_float(x.y << 16); s[3] += __uint_as_float(x.y & 0xffff0000u);
                        s[4] += __uint_as_float(x.z << 16); s[5] += __uint_as_float(x.z & 0xffff0000u); s[6] += __uint_as_float(x.w << 16); s[7] += __uint_as_float(x.w & 0xffff0000u); }
                    float hv[8], lv[8];
#pragma unroll
                    for (int e = 0; e < 8; ++e) { float m = s[e]; m += __shfl_xor(m, 16); m += __shfl_xor(m, 32); m *= (1.0f / 256.0f); const float hf = bf2f(f2bf(m)); hv[e] = hf; lv[e] = m - hf; }
                    if (rq == 0) { const size_t o = ((size_t)(h * NBLK + blk)) * 128 + cv * 8;
                        *(u32x4*)(KMH_ + o) = (u32x4){pk2(hv[0], hv[1]), pk2(hv[2], hv[3]), pk2(hv[4], hv[5]), pk2(hv[6], hv[7])};
                        *(u32x4*)(KML_ + o) = (u32x4){pk2(lv[0], lv[1]), pk2(lv[2], lv[3]), pk2(lv[4], lv[5]), pk2(lv[6], lv[7])}; }
                }
                }
                grid.sync();
            }
            { PH_VARS(); gate_phase(U_, KMH_, KML_, SEL_, gw, NGW, lane); }
        }
        __syncthreads();
        { PH_VARS();
        const bf16_t* MK = MKV_ + (size_t)layer * 256 * 1024;
        for (int u = blockIdx.x; u < 256; u += G) { const int qt = u >> 2, hm = u & 3;
            att::Out ot{}; ot.U = U_; ot.MIX = MIX_; ot.t0 = qt * 256; ot.head = hm;
            const bf16_t* Qrow = U_ + (size_t)(qt * 256 + wid * 32 + (lane & 31)) * INW + 3072 + hm * 128;
#ifndef NO_ATT0
            att::attn_unit<0>(Qrow, MK + hm * 128, MK + 512 + hm * 128, 1024, (char*)lds, ot);
#endif
            __syncthreads(); }
        }
        grid.sync();
        if (layer < 2) {
            pg8::Gemm g{POOLED_, WPOOL_ + (size_t)layer * BW * BW, S, BW, BW}; pg8::StaticOrder So; So.init(g.M, g.N, G, (int)blockIdx.x);
            EpiPool E{MIX_, U_, p.pool_scale + (size_t)layer * BW};
#ifndef NO_GP
            pg8::gemm_phase<EpiPool, pg8::StaticOrder, true, true>(ldsl, g, So, E);
#endif
        } else {
            { PH_VARS();
            for (int li = gw; li < NLIST; li += NGW) { const int h = li / 63, j = li - h * 63;
                unsigned short* L = LISTS_ + (size_t)h * LIST_PER_HEAD + 256 * (63 * j - (j * (j - 1)) / 2); int base = 0;
                for (int q0 = (j + 1) * 256; q0 < S; q0 += 256) { unsigned sv[4];
#pragma unroll
                    for (int i = 0; i < 4; ++i) sv[i] = SEL_[(size_t)h * S + q0 + 64 * i + lane];
#pragma unroll
                    for (int i = 0; i < 4; ++i) { const unsigned x = sv[i]; const int slot = ((x & 255u) == (unsigned)j) ? 0 : ((((x >> 8) & 255u) == (unsigned)j) ? 1 : ((((x >> 16) & 255u) == (unsigned)j) ? 2 : -1));
                        const bool hit = slot >= 0; const unsigned long long bal = __ballot(hit); const int pos = base + __popcll(bal & ((1ull << lane) - 1ull));
                        if (hit) L[pos] = (unsigned short)((q0 + 64 * i + lane) * 4 + slot); base += __popcll(bal); } }
                if (lane == 0) CNT_[li] = base; }
            }
            grid.sync();
            { PH_VARS();
            if (wid == 0) { int carry = 0;
                for (int c = 0; c < 12; ++c) { const int idx = c * 64 + lane; int v = (idx < NLIST) ? ((CNT_[idx] + 255) >> 8) : 0; int incl = v;
#pragma unroll
                    for (int o = 1; o < 64; o <<= 1) { const int n = __shfl_up(incl, o); if (lane >= o) incl += n; }
                    if (idx < NLIST) pref[idx] = carry + incl - v; carry += __shfl(incl, 63); }
                if (lane == 0) pref[NLIST] = carry; }
            __syncthreads();
            const int total = pref[NLIST];
            for (int u = blockIdx.x; u < total; u += G) {
                int lo = 0, hi_ = NLIST - 1;
                while (lo < hi_) { const int mid = (lo + hi_ + 1) >> 1; if (pref[mid] <= u) lo = mid; else hi_ = mid - 1; }
                const int li = lo, h = li / 63, j = li - h * 63, tt = u - pref[li], cnt = CNT_[li];
                const unsigned short* L = LISTS_ + (size_t)h * LIST_PER_HEAD + 256 * (63 * j - (j * (j - 1)) / 2) + tt * 256;
                const int ridx = wid * 32 + (lane & 31); const bool valid = (tt * 256 + ridx) < cnt;
                const int e = valid ? (int)L[ridx] : (int)L[0];
                att::Out ot{}; ot.PART = PART_; ot.ML = ML_; ot.head = h; ot.ent = valid ? e : -1;
                const bf16_t* Qrow = U_ + (size_t)(e >> 2) * INW + h * 128;
#ifndef NO_ATT1
                att::attn_unit<1>(Qrow, KB_ + (size_t)(j * 256) * BW + h * 128, VB_ + (size_t)(j * 256) * BW + h * 128, BW, (char*)lds, ot);
#endif
                __syncthreads(); }
            }
            grid.sync();
            { PH_VARS();
            for (int u = blockIdx.x; u < NBLK * NH; u += G) { const int b = u / NH, h = u - b * NH;
                att::Out ot{}; ot.U = U_; ot.MIX = MIX_; ot.PART = PART_; ot.ML = ML_; ot.t0 = b * 256; ot.head = h; ot.nvalid = b < 3 ? b : 3;
                const bf16_t* Qrow = U_ + (size_t)(b * 256 + wid * 32 + (lane & 31)) * INW + h * 128;
#ifndef NO_ATT2
                att::attn_unit<2>(Qrow, KB_ + (size_t)(b * 256) * BW + h * 128, VB_ + (size_t)(b * 256) * BW + h * 128, BW, (char*)lds, ot);
#endif
                __syncthreads(); }
            }
        }
        grid.sync();
        {
            pg8::Gemm g{MIX_, WOUT_, S, DM, DM}; pg8::StaticOrder So; So.init(g.M, g.N, G, (int)blockIdx.x);
            EpiRes E{layer == 0 ? p.x : p.out, p.out};
#ifndef NO_G2
            pg8::gemm_phase<EpiRes, pg8::StaticOrder, true, true>(ldsl, g, So, E);
#endif
        }
        grid.sync();
        { PH_VARS();
            const float* lg = p.ln_g + (size_t)layer * DM; const float* lb = p.ln_b + (size_t)layer * DM;
            for (int row = gw; row < S; row += NGW) { f32x4* zr = (f32x4*)(p.out + (size_t)row * DM) + lane; f32x4 v[8]; float s = 0.f;
#pragma unroll
                for (int j = 0; j < 8; ++j) { v[j] = zr[64 * j]; s += (v[j][0] + v[j][1]) + (v[j][2] + v[j][3]); }
                const float mean = wave_sum(s) * (1.0f / DM); float s2 = 0.f;
#pragma unroll
                for (int j = 0; j < 8; ++j) { v[j] = v[j] - mean; s2 += (v[j][0] * v[j][0] + v[j][1] * v[j][1]) + (v[j][2] * v[j][2] + v[j][3] * v[j][3]); }
                const float rstd = 1.0f / sqrtf(wave_sum(s2) * (1.0f / DM) + LN_EPS);
                u32x2* hb = (u32x2*)(HB_ + (size_t)row * DM) + lane;
#pragma unroll
                for (int j = 0; j < 8; ++j) { const f32x4 gg = *((const f32x4*)lg + lane + 64 * j), bb = *((const f32x4*)lb + lane + 64 * j);
                    const f32x4 o = v[j] * rstd * gg + bb; zr[64 * j] = o;
                    if (layer < 3) hb[64 * j] = (u32x2){pk2(o[0], o[1]), pk2(o[2], o[3])}; }
            }
            if (layer < 3) {
                __syncthreads();
                transpose_matrix(p.w_in + (size_t)(layer + 1) * DM * INW, DM, INW, INW, WIN_, DM, scr, gw, NGW, lane);
                transpose_matrix(p.w_out + (size_t)(layer + 1) * DM * DM, DM, DM, DM, WOUT_, DM, scr, gw, NGW, lane);
            }
        }
        if (layer < 3) grid.sync();
    }
}

extern "C" void kernel_launch(void* const* d_in, const int* in_sizes, int n_in, void* d_out, int out_size, void* d_ws, size_t ws_size, hipStream_t stream) {
    static int grid = 0;
    if (grid == 0) {
        if (n_in != 10 || in_sizes[0] != S * DM || out_size != S * DM || ws_size < WS_END) {
            fprintf(stderr, "kernel_launch: unexpected shapes (n_in %d, x %d, out %d, ws %zu < %zu); nothing launched\n", n_in, n_in > 0 ? in_sizes[0] : -1, out_size, ws_size, (size_t)WS_END); grid = -1; return; }
        int dev = 0, cus = 0, per_cu = 0;
        if (hipGetDevice(&dev) != hipSuccess || hipDeviceGetAttribute(&cus, hipDeviceAttributeMultiprocessorCount, dev) != hipSuccess) { grid = -1; return; }
        if (hipFuncSetAttribute((const void*)yoco_fwd, hipFuncAttributeMaxDynamicSharedMemorySize, LDS_BYTES) != hipSuccess) { fprintf(stderr, "kernel_launch: hipFuncSetAttribute failed\n"); grid = -1; return; }
        if (hipOccupancyMaxActiveBlocksPerMultiprocessor(&per_cu, (const void*)yoco_fwd, 512, LDS_BYTES) != hipSuccess || per_cu < 1) { fprintf(stderr, "kernel_launch: occupancy query says %d\n", per_cu); per_cu = 1; }
        (void)hipGetLastError();
        grid = cus * 1;
    }
    if (grid < 0) return;
    Params p{};
    p.x = (const float*)d_in[0]; p.mem = (const float*)d_in[1]; p.w_in = (const float*)d_in[2]; p.w_out = (const float*)d_in[3]; p.w_mkv = (const float*)d_in[4];
    p.ln_g = (const float*)d_in[5]; p.ln_b = (const float*)d_in[6]; p.pool_w = (const float*)d_in[7]; p.pool_scale = (const float*)d_in[8]; p.w_kv = (const float*)d_in[9];
    p.out = (float*)d_out; p.ws = (unsigned char*)d_ws;
    void* args[] = {&p};
    hipError_t e = hipLaunchCooperativeKernel((const void*)yoco_fwd, dim3(grid), dim3(512), args, LDS_BYTES, stream);
    if (e != hipSuccess) fprintf(stderr, "kernel_launch: cooperative launch failed: %s (grid %d)\n", hipGetErrorString(e), grid);
}
```
